# Optimizing an MI355X kernel written in HIP

```python
import math
import jax, jax.numpy as jnp
from jax import lax
import numpy as np

D_MODEL = 1024
BATCH = 16
SEQ = 2048
DEPTH = 1

HEAD_DIM = 64
N_HEADS_DIL = D_MODEL // (2 * HEAD_DIM)
N_HEADS_NA = D_MODEL // (2 * HEAD_DIM)
WIDTH_DIL = N_HEADS_DIL * HEAD_DIM
WIDTH_NA = N_HEADS_NA * HEAD_DIM
MIX_WIDTH = WIDTH_DIL + WIDTH_NA
DIL_PATTERNS = ((128, 1), (512, 4), (2048, 16))
DIL_BLOCK = 64
GRID_W = 64
NA_WIN_ROWS = 8
NA_WIN_COLS = 16
NA_Q_ROWS = 4
NA_Q_COLS = 16
NA_K_COLS = 32
N_GROUPS = 4
EXPERTS_PER_GROUP = 4
N_EXPERTS = N_GROUPS * EXPERTS_PER_GROUP
TOP_K_EXPERT = 2
D_EXPERT = 256
RMS_EPS = 1e-6
NEG_INF = -1e30

kernel_name = 'hybrid_dilated_neighbourhood_hmoe_encoder'


def rms_norm(x, gain):
    xf = x.astype(jnp.float32)
    xf = xf * lax.rsqrt(jnp.mean(xf * xf, axis=-1, keepdims=True) + RMS_EPS)
    return (xf * gain.astype(jnp.float32)).astype(x.dtype)


def alibi_slopes(n_heads):
    return jnp.exp2(-8.0 * jnp.arange(1, n_heads + 1, dtype=jnp.float32) / n_heads)


def dilated_window_attention(q, k, v, slopes, window, dilation):
    B, H, S, Dh = q.shape
    L = S // dilation
    radius = (window // 2) // dilation
    blk = DIL_BLOCK
    n_blk = -(-L // blk)
    Lp = n_blk * blk

    def residue_major(t, lo, hi):
        t = t.reshape(B, H, L, dilation, Dh).transpose(0, 1, 3, 2, 4)
        return jnp.pad(t, ((0, 0), (0, 0), (0, 0), (lo, hi), (0, 0)))

    def key_blocks(t):
        tp = residue_major(t, blk, Lp - L + blk).reshape(B, H, dilation, n_blk + 2, blk, Dh)
        return jnp.concatenate([tp[:, :, :, i:i + n_blk] for i in range(3)], axis=4)

    qb = residue_major(q, 0, Lp - L).reshape(B, H, dilation, n_blk, blk, Dh)
    kb = key_blocks(k)
    vb = key_blocks(v)

    q_pos = jnp.arange(Lp).reshape(n_blk, blk)
    k_pos = (jnp.arange(n_blk)[:, None] - 1) * blk + jnp.arange(3 * blk)[None, :]
    off = jnp.abs(k_pos[:, None, :] - q_pos[:, :, None])
    valid = ((off <= radius) & (k_pos[:, None, :] >= 0) & (k_pos[:, None, :] < L)
             & (q_pos[:, :, None] < L))
    dist = (off * dilation).astype(jnp.float32)

    s = jnp.einsum('bhrnqd,bhrnkd->bhrnqk', qb, kb).astype(jnp.float32) * (HEAD_DIM ** -0.5)
    s = s - slopes[None, :, None, None, None, None] * dist
    s = jnp.where(valid, s, NEG_INF)
    mx = jnp.max(s, axis=-1, keepdims=True)
    p = jnp.exp(s - mx)
    den = jnp.sum(p, axis=-1)
    o = jnp.einsum('bhrnqk,bhrnkd->bhrnqd', p, vb.astype(jnp.float32)) / den[..., None]
    lse = mx[..., 0] + jnp.log(den)

    o = o.reshape(B, H, dilation, Lp, Dh)[:, :, :, :L].transpose(0, 1, 3, 2, 4).reshape(B, H, S, Dh)
    lse = lse.reshape(B, H, dilation, Lp)[..., :L].transpose(0, 1, 3, 2).reshape(B, H, S)
    return o, lse


def dilated_mixture_attention(q, k, v, slopes):
    results = [dilated_window_attention(q, k, v, slopes, w, d) for (w, d) in DIL_PATTERNS]
    outs = jnp.stack([r[0] for r in results])
    lses = jnp.stack([r[1] for r in results])
    weights = jax.nn.softmax(lses, axis=0)
    return jnp.sum(weights[..., None] * outs, axis=0).astype(q.dtype)


def neighbourhood_attention(q, k, v, rpb):
    B, H, S, Dh = q.shape
    rows = S // GRID_W
    wh = min(NA_WIN_ROWS, rows)
    q_rows = math.gcd(rows, NA_Q_ROWS)
    k_rows = min(wh + q_rows - 1, rows)
    n_rb = rows // q_rows
    n_cb = GRID_W // NA_Q_COLS

    r = jnp.arange(rows)
    c = jnp.arange(GRID_W)
    row_start = jnp.clip(r - wh // 2, 0, rows - wh)
    col_start = jnp.clip(c - NA_WIN_COLS // 2, 0, GRID_W - NA_WIN_COLS)
    key_row = jnp.clip(row_start[::q_rows], 0, rows - k_rows)[:, None] + jnp.arange(k_rows)
    key_col = (jnp.clip(jnp.arange(n_cb) * NA_Q_COLS - NA_WIN_COLS // 2, 0, GRID_W - NA_K_COLS)[:, None]
               + jnp.arange(NA_K_COLS))

    q_row = r.reshape(n_rb, q_rows)
    q_col = c.reshape(n_cb, NA_Q_COLS)
    rs = row_start.reshape(n_rb, q_rows)[:, :, None]
    cs = col_start.reshape(n_cb, NA_Q_COLS)[:, :, None]
    row_ok = (key_row[:, None, :] >= rs) & (key_row[:, None, :] < rs + wh)
    col_ok = (key_col[:, None, :] >= cs) & (key_col[:, None, :] < cs + NA_WIN_COLS)
    mask = row_ok[:, None, :, None, :, None] & col_ok[None, :, None, :, None, :]
    dr = jnp.clip(key_row[:, None, :] - q_row[:, :, None] + NA_WIN_ROWS - 1, 0, 2 * NA_WIN_ROWS - 2)
    dc = jnp.clip(key_col[:, None, :] - q_col[:, :, None] + NA_WIN_COLS - 1, 0, 2 * NA_WIN_COLS - 2)
    bias = rpb[:, dr[:, None, :, None, :, None], dc[None, :, None, :, None, :]].astype(jnp.float32)

    def grid(t):
        return t.reshape(B, H, rows, GRID_W, Dh)

    qb = grid(q).reshape(B, H, n_rb, q_rows, n_cb, NA_Q_COLS, Dh).transpose(0, 1, 2, 4, 3, 5, 6)
    ridx = key_row[:, None, :, None]
    cidx = key_col[None, :, None, :]
    kg = grid(k)[:, :, ridx, cidx]
    vg = grid(v)[:, :, ridx, cidx]

    s = jnp.einsum('bhijqcd,bhijkld->bhijqckl', qb, kg).astype(jnp.float32) * (HEAD_DIM ** -0.5)
    s = jnp.where(mask, s + bias[None], NEG_INF)
    p = jax.nn.softmax(s, axis=(-2, -1))
    o = jnp.einsum('bhijqckl,bhijkld->bhijqcd', p, vg.astype(jnp.float32))
    o = o.transpose(0, 1, 2, 4, 3, 5, 6).reshape(B, H, S, Dh)
    return o.astype(q.dtype)


def hierarchical_moe(x, w_group, b_group, w_router, b_router, w_gate, w_up, w_down):
    B, S, D = x.shape
    n_tok = B * S
    xf = x.reshape(n_tok, D)
    g_logits = (xf @ w_group).astype(jnp.float32) + b_group.astype(jnp.float32)
    g_weight, g_idx = lax.top_k(jax.nn.softmax(g_logits, axis=-1), 1)
    e_logits = ((xf @ w_router).astype(jnp.float32) + b_router.astype(jnp.float32)
                ).reshape(n_tok, N_GROUPS, EXPERTS_PER_GROUP)
    e_in_group = jnp.take_along_axis(e_logits, g_idx[:, :, None], axis=1)[:, 0]
    e_val, e_idx = lax.top_k(e_in_group, TOP_K_EXPERT)
    e_weight = jax.nn.softmax(e_val, axis=-1) * g_weight
    expert_id = g_idx * EXPERTS_PER_GROUP + e_idx
    combine = jnp.sum(jax.nn.one_hot(expert_id, N_EXPERTS, dtype=jnp.float32) * e_weight[..., None], axis=1)
    gate = jnp.einsum('nd,edf->nef', xf, w_gate)
    up = jnp.einsum('nd,edf->nef', xf, w_up)
    act = jax.nn.silu(gate) * up * combine[:, :, None].astype(x.dtype)
    out = jnp.einsum('nef,efd->nd', act, w_down)
    return out.reshape(B, S, D).astype(x.dtype)


def setup_inputs(seed: int = 0) -> dict:
    key = jax.random.key(seed)
    ks = jax.random.split(key, 17)
    f32 = jnp.float32

    def nrm(k, shape, scale):
        return jax.random.normal(k, shape, f32) * scale

    return {
        'x': nrm(ks[0], (BATCH, SEQ, D_MODEL), 1.0),
        'norm_mix_g': 1.0 + nrm(ks[1], (DEPTH, D_MODEL), 0.02),
        'w_in': nrm(ks[2], (DEPTH, D_MODEL, 3 * MIX_WIDTH), D_MODEL ** -0.5),
        'rpb': nrm(ks[3], (DEPTH, N_HEADS_NA, 2 * NA_WIN_ROWS - 1, 2 * NA_WIN_COLS - 1), 0.1),
        'g_out_dil': 1.0 + nrm(ks[4], (DEPTH, WIDTH_DIL), 0.02),
        'g_out_na': 1.0 + nrm(ks[5], (DEPTH, WIDTH_NA), 0.02),
        'w_out': nrm(ks[6], (DEPTH, MIX_WIDTH, D_MODEL), MIX_WIDTH ** -0.5),
        'norm_ffn_g': 1.0 + nrm(ks[7], (DEPTH, D_MODEL), 0.02),
        'w_group': nrm(ks[8], (DEPTH, D_MODEL, N_GROUPS), D_MODEL ** -0.5),
        'b_group': nrm(ks[9], (DEPTH, N_GROUPS), 0.01),
        'w_router': nrm(ks[10], (DEPTH, D_MODEL, N_EXPERTS), D_MODEL ** -0.5),
        'b_router': nrm(ks[11], (DEPTH, N_EXPERTS), 0.01),
        'w_gate': nrm(ks[12], (DEPTH, N_EXPERTS, D_MODEL, D_EXPERT), D_MODEL ** -0.5),
        'w_up': nrm(ks[13], (DEPTH, N_EXPERTS, D_MODEL, D_EXPERT), D_MODEL ** -0.5),
        'w_down': nrm(ks[14], (DEPTH, N_EXPERTS, D_EXPERT, D_MODEL), D_EXPERT ** -0.5),
        'norm_final_g': 1.0 + nrm(ks[15], (D_MODEL,), 0.02),
    }


def reference(x, norm_mix_g, w_in, rpb, g_out_dil, g_out_na, w_out, norm_ffn_g,
              w_group, b_group, w_router, b_router, w_gate, w_up, w_down, norm_final_g):
    B, S, _ = x.shape
    slopes = alibi_slopes(N_HEADS_DIL)
    h = x
    for layer in range(DEPTH):
        hn = rms_norm(h, norm_mix_g[layer])
        proj = hn @ w_in[layer]
        p_dil = proj[..., :3 * WIDTH_DIL].reshape(B, S, 3, N_HEADS_DIL, HEAD_DIM).transpose(2, 0, 3, 1, 4)
        p_na = proj[..., 3 * WIDTH_DIL:].reshape(B, S, 3, N_HEADS_NA, HEAD_DIM).transpose(2, 0, 3, 1, 4)
        y_dil = dilated_mixture_attention(p_dil[0], p_dil[1], p_dil[2], slopes)
        y_na = neighbourhood_attention(p_na[0], p_na[1], p_na[2], rpb[layer])
        y_dil = rms_norm(y_dil.transpose(0, 2, 1, 3).reshape(B, S, WIDTH_DIL), g_out_dil[layer])
        y_na = rms_norm(y_na.transpose(0, 2, 1, 3).reshape(B, S, WIDTH_NA), g_out_na[layer])
        h = h + jnp.concatenate([y_dil, y_na], axis=-1) @ w_out[layer]
        h = h + hierarchical_moe(rms_norm(h, norm_ffn_g[layer]), w_group[layer], b_group[layer],
                                 w_router[layer], b_router[layer], w_gate[layer], w_up[layer], w_down[layer])
    return rms_norm(h, norm_final_g)
```

```cpp
#include <hip/hip_runtime.h>
#include <cstdint>
#include <cstdio>

#ifndef FAST_UPTO
#define FAST_UPTO 5
#endif

namespace cfg {
constexpr int B = 16, S = 2048, D = 1024, M = B * S, NH = 8, HD = 64, NQKV = 3072;
constexpr int NG = 4, EPG = 4, NE = 16, DE = 256, NCLS = 24;
constexpr float EPS = 1e-6f;
constexpr float LOG2E = 1.4426950408889634f;
constexpr float QSCALE = 0.125f * LOG2E;
}
using namespace cfg;

#define LAS __attribute__((address_space(3)))
#define GAS __attribute__((address_space(1)))
typedef unsigned short bf16;
typedef unsigned v4u __attribute__((ext_vector_type(4)));
typedef unsigned v2u __attribute__((ext_vector_type(2)));
typedef float f32x4 __attribute__((ext_vector_type(4)));
typedef float f32x2 __attribute__((ext_vector_type(2)));
typedef GAS unsigned gu32;

__device__ __forceinline__ float wave_sum(float v) {
#pragma unroll
    for (int o = 32; o >= 1; o >>= 1) v += __shfl_xor(v, o);
    return v;
}
__device__ __forceinline__ unsigned f2bf(float f) { unsigned u = __builtin_bit_cast(unsigned, f); return (u + 0x7fffu + ((u >> 16) & 1u)) >> 16; }
__device__ __forceinline__ unsigned pk2(float lo, float hi) { return f2bf(lo) | (f2bf(hi) << 16); }
__device__ __forceinline__ float bf2f(unsigned short b) { return __builtin_bit_cast(float, (unsigned)b << 16); }
__device__ __forceinline__ float bflo(unsigned w) { return __builtin_bit_cast(float, w << 16); }
__device__ __forceinline__ float bfhi(unsigned w) { return __builtin_bit_cast(float, w & 0xffff0000u); }

constexpr size_t MiB = 1u << 20;
constexpr size_t WS_CTL = 0, CTL_ZERO_BYTES = 1 * MiB;
constexpr size_t WS_WIN = 2 * MiB;
constexpr size_t WS_WOUT = 8 * MiB;
constexpr size_t WS_WGU = 10 * MiB;
constexpr size_t WS_WDP = 26 * MiB;
constexpr size_t WS_ROUTE = 50 * MiB;
constexpr size_t WS_PERM = 51 * MiB;
constexpr size_t WS_SS = 54 * MiB;
constexpr size_t WS_SSF = 56 * MiB;
constexpr size_t WS_XN = 64 * MiB;
constexpr size_t WS_QKV = 128 * MiB;
constexpr size_t WS_HID = 128 * MiB;
constexpr size_t WS_Y = 320 * MiB;
constexpr size_t WS_NAIVE = 384 * MiB;
constexpr size_t WS_END = 512 * MiB;
constexpr int CW_TMO = 0, CW_CODE = 1;
constexpr int CW_CNT = 64;
constexpr int CW_BAR = 4096;
namespace pg8 {
#define PG8_LAS __attribute__((address_space(3)))
typedef unsigned short bf16_t;
typedef short bf16x8 __attribute__((ext_vector_type(8)));
typedef float f32x4 __attribute__((ext_vector_type(4)));
typedef unsigned u32x4 __attribute__((ext_vector_type(4)));
constexpr int BM = 256, BK = 64, HALF = 128, HTB = HALF * BK * 2  , STAGE_BYTES = 8 * HTB, NXCD = 8, WGM = 8;

__host__ __device__ __forceinline__ int lds_byte(int r, int c) { const int st = (r >> 4) * 2 + (c >> 5), rr = r & 15, cc = c & 31, ob = rr * 64 + cc * 2; return st * 1024 + (ob ^ (((ob >> 9) & 1) << 5)); }
__host__ __device__ __forceinline__ void stage_rc(int b, int& R, int& C) { const int st = b / 1024, sb = b % 1024, swz = sb ^ (((sb >> 9) & 1) << 5); R = (st >> 1) * 16 + swz / 64; C = (st & 1) * 32 + (swz % 64) / 2; }
__host__ __device__ __forceinline__ int perm32(int rho) { const int n = rho >> 4, i = rho & 15; return 8 * (i >> 2) + 4 * n + (i & 3); }

struct Unit { int pm, pn, ord, cls, slot0, nvalid; };

__device__ __forceinline__ unsigned cvt_pk_bf16(float lo, float hi) { unsigned r; asm volatile("v_cvt_pk_bf16_f32 %0, %1, %2" : "=v"(r) : "v"(lo), "v"(hi)); return r; }

struct StaticOrder {
    static constexpr bool GATHER = false;
    const char* A; const char* Bt; int K;
    int nM, nN, nwg, G, c;
    __device__ void init(const void* A_, const void* Bt_, int M, int N, int K_, int G_, int c_) { A = (const char*)A_; Bt = (const char*)Bt_; K = K_; nM = M / BM; nN = N / BM; nwg = nM * nN; G = G_; c = c_; }
    __device__ bool next(int i, Unit& u) const {
        const long L = (long)i * G + c; if (L >= nwg) return false;
        int wgid = (int)L; { const int q = nwg / NXCD, r = nwg % NXCD, xcd = wgid % NXCD, off = wgid / NXCD; wgid = (xcd < r ? xcd * (q + 1) : r * (q + 1) + (xcd - r) * q) + off; }
        const int nig = WGM * nN, gid = wgid / nig, fm = gid * WGM, gsz = (nM - fm) < WGM ? (nM - fm) : WGM;
        u.pm = fm + ((wgid % nig) % gsz); u.pn = (wgid % nig) / gsz; u.ord = i; u.cls = 0; u.slot0 = 0; u.nvalid = BM; return true;
    }
    __device__ __forceinline__ const char* a_base(const Unit& u) const { return A + (size_t)u.pm * BM * K * 2; }
    __device__ __forceinline__ const char* b_base(const Unit& u) const { return Bt + (size_t)u.pn * BM * K * 2; }
    __device__ __forceinline__ int gather_row(const Unit&, int r) const { return r; }
};

template <class Epi, class Sched, bool ALIGN_EPI>
__device__ __forceinline__ void gemm_phase(PG8_LAS unsigned char* lds, const int K, const Sched& S, const Epi& E) {
    const int tid = threadIdx.x, wid = __builtin_amdgcn_readfirstlane(tid >> 6), lane = tid & 63, wr = wid >> 2, wc = wid & 3, fr = lane & 15, fq = lane >> 4;
    const int nt = K / BK;
    int RA[2], CA[2]; unsigned voffB[2];
#pragma unroll
    for (int i = 0; i < 2; ++i) { int R, C; stage_rc(tid * 16 + i * 8192, R, C); const int Rb = Epi::PERM ? ((R & ~31) + perm32(R & 31)) : R; RA[i] = R; CA[i] = C; voffB[i] = (unsigned)(Rb * K + C) * 2u; }
    const size_t kstep = (size_t)(BK * 2);
    const size_t hstep = (size_t)HALF * K * 2;
    const unsigned ldsw = (unsigned)wid * 1024u;
    const int aoff = lds_byte(wr * 64 + fr, fq * 8), boff = lds_byte(wc * 32 + fr, fq * 8);
#define PG8_SA(b, h) (((b) * 2 + (h)) * HTB)
#define PG8_SB(b, h) ((4 + (b) * 2 + (h)) * HTB)
#define PG8_STAGE2(bufoff, gbase, v0, v1) do { \
        __builtin_amdgcn_global_load_lds((const unsigned*)((const char*)(gbase) + (v0)), (PG8_LAS unsigned*)(lds + (bufoff) + ldsw), 16, 0, 0); \
        __builtin_amdgcn_global_load_lds((const unsigned*)((const char*)(gbase) + (v1)), (PG8_LAS unsigned*)(lds + (bufoff) + ldsw + 8192), 16, 0, 0); } while (0)
#define PG8_STAGEB(bufoff, gbase) PG8_STAGE2(bufoff, gbase, voffB[0], voffB[1])
#define PG8_LDA(dst, b, h) do { _Pragma("unroll") for (int m = 0; m < 4; ++m) _Pragma("unroll") for (int k = 0; k < 2; ++k) dst[m][k] = *(const PG8_LAS bf16x8*)(lds + PG8_SA(b, h) + aoff + m * 2048 + k * 1024); } while (0)
#define PG8_LDB(dst, b, h) do { _Pragma("unroll") for (int n = 0; n < 2; ++n) _Pragma("unroll") for (int k = 0; k < 2; ++k) dst[n][k] = *(const PG8_LAS bf16x8*)(lds + PG8_SB(b, h) + boff + n * 2048 + k * 1024); } while (0)
#define PG8_MMA(ai, bj, At, Bt) do { __builtin_amdgcn_s_setprio(1); _Pragma("unroll") for (int m = 0; m < 4; ++m) _Pragma("unroll") for (int n = 0; n < 2; ++n) _Pragma("unroll") for (int k = 0; k < 2; ++k) \
        acc[ai][bj][m][n] = __builtin_amdgcn_mfma_f32_16x16x32_bf16(Bt[n][k], At[m][k], acc[ai][bj][m][n], 0, 0, 0); __builtin_amdgcn_s_setprio(0); } while (0)
#define PG8_WAIT_V(n) asm volatile("s_waitcnt vmcnt(" #n ")" ::: "memory")
#define PG8_WAIT_L(n) asm volatile("s_waitcnt lgkmcnt(" #n ")" ::: "memory")
#define PG8_BAR __builtin_amdgcn_s_barrier()
#define PG8_SCHED __builtin_amdgcn_sched_barrier(0)
#define PG8_VOFF(dst, u) do { _Pragma("unroll") for (int h_ = 0; h_ < 2; ++h_) _Pragma("unroll") for (int i_ = 0; i_ < 2; ++i_) \
        dst[h_][i_] = (unsigned)(S.gather_row(u, h_ * HALF + RA[i_]) * K + CA[i_]) * 2u; } while (0)
    Unit cur, nxt; int ui = 0;
    if (!S.next(0, cur)) return;
    f32x4 acc[2][2][4][2];
#pragma unroll
    for (int a = 0; a < 2; ++a)
#pragma unroll
        for (int b = 0; b < 2; ++b)
#pragma unroll
            for (int m = 0; m < 4; ++m)
#pragma unroll
                for (int n = 0; n < 2; ++n) acc[a][b][m][n] = (f32x4){0.f, 0.f, 0.f, 0.f};
    bf16x8 At[4][2], B0[2][2], B1[2][2];
    unsigned vA[2][2], vN[2][2];
    PG8_VOFF(vA, cur);
    const char* cA = S.a_base(cur); const char* cB = S.b_base(cur);
    PG8_STAGEB(PG8_SB(0, 0), cB); PG8_STAGEB(PG8_SB(0, 1), cB + hstep); PG8_STAGE2(PG8_SA(0, 0), cA, vA[0][0], vA[0][1]); PG8_STAGE2(PG8_SA(0, 1), cA, vA[1][0], vA[1][1]);
    if (wr == 1) PG8_BAR;
    PG8_WAIT_V(2); PG8_BAR;
    PG8_STAGEB(PG8_SB(1, 0), cB + kstep); PG8_STAGE2(PG8_SA(1, 0), cA + kstep, vA[0][0], vA[0][1]); PG8_STAGEB(PG8_SB(1, 1), cB + hstep + kstep);
    PG8_WAIT_V(6); PG8_BAR;
    for (;;) {
        const bool has_next = S.next(ui + 1, nxt);
        const char* nA = has_next ? S.a_base(nxt) : cA; const char* nB = has_next ? S.b_base(nxt) : cB;
        if (Sched::GATHER && has_next) { PG8_VOFF(vN, nxt); } else {
#pragma unroll
            for (int h_ = 0; h_ < 2; ++h_)
#pragma unroll
                for (int i_ = 0; i_ < 2; ++i_) vN[h_][i_] = vA[h_][i_]; }
        for (int t = 0; t < nt; t += 2) {
            const bool last = (t == nt - 2);
            if constexpr (Epi::MIDK) { if (t == (nt >> 1)) E.midk(acc, cur, wr, fr); }
            const char* a1 = cA + (size_t)(t + 1) * kstep;
            const char* a2 = last ? nA : cA + (size_t)(t + 2) * kstep; const char* b2 = last ? nB : cB + (size_t)(t + 2) * kstep;
            const char* a3 = a2 + kstep; const char* b3 = b2 + kstep;
            const unsigned w00 = last ? vN[0][0] : vA[0][0], w01 = last ? vN[0][1] : vA[0][1], w10 = last ? vN[1][0] : vA[1][0], w11 = last ? vN[1][1] : vA[1][1];
            PG8_LDB(B0, 0, 0); PG8_LDB(B1, 0, 1); PG8_SCHED; PG8_LDA(At, 0, 0); PG8_STAGE2(PG8_SA(1, 1), a1, vA[1][0], vA[1][1]);
            PG8_WAIT_V(8); PG8_WAIT_L(0); PG8_BAR; PG8_MMA(0, 0, At, B0); PG8_MMA(0, 1, At, B1); PG8_BAR; PG8_SCHED;
            PG8_LDA(At, 0, 1); PG8_STAGEB(PG8_SB(0, 0), b2); PG8_STAGEB(PG8_SB(0, 1), b2 + hstep); PG8_STAGE2(PG8_SA(0, 0), a2, w00, w01);
            PG8_WAIT_V(8); PG8_WAIT_L(0); PG8_BAR; PG8_MMA(1, 0, At, B0); PG8_MMA(1, 1, At, B1); PG8_BAR; PG8_SCHED;
            PG8_LDB(B0, 1, 0); PG8_LDB(B1, 1, 1); PG8_SCHED; PG8_LDA(At, 1, 0); PG8_STAGE2(PG8_SA(0, 1), a2, w10, w11);
            PG8_WAIT_V(8); PG8_WAIT_L(0); PG8_BAR; PG8_MMA(0, 0, At, B0); PG8_MMA(0, 1, At, B1); PG8_BAR; PG8_SCHED;
            PG8_LDA(At, 1, 1); PG8_STAGEB(PG8_SB(1, 0), b3); PG8_STAGEB(PG8_SB(1, 1), b3 + hstep); PG8_STAGE2(PG8_SA(1, 0), a3, w00, w01);
            PG8_WAIT_V(8); PG8_WAIT_L(0); PG8_BAR; PG8_MMA(1, 0, At, B0); PG8_MMA(1, 1, At, B1); PG8_BAR; PG8_SCHED;
        }
        if constexpr (ALIGN_EPI) { if (wr == 0) PG8_BAR; }
        E(acc, cur, wr, wc, fr, fq);
        if (!has_next) break;
#pragma unroll
        for (int a = 0; a < 2; ++a)
#pragma unroll
            for (int b = 0; b < 2; ++b)
#pragma unroll
                for (int m = 0; m < 4; ++m)
#pragma unroll
                    for (int n = 0; n < 2; ++n) acc[a][b][m][n] = (f32x4){0.f, 0.f, 0.f, 0.f};
        cur = nxt; cA = nA; cB = nB; ++ui;
#pragma unroll
        for (int h_ = 0; h_ < 2; ++h_)
#pragma unroll
            for (int i_ = 0; i_ < 2; ++i_) vA[h_][i_] = vN[h_][i_];
        if constexpr (ALIGN_EPI) { if (wr == 1) PG8_BAR; }
    }
    PG8_WAIT_V(0);
    if constexpr (!ALIGN_EPI) { if (wr == 0) PG8_BAR; }
    PG8_BAR;
#undef PG8_SA
#undef PG8_SB
#undef PG8_STAGE2
#undef PG8_STAGEB
#undef PG8_LDA
#undef PG8_LDB
#undef PG8_MMA
#undef PG8_WAIT_V
#undef PG8_WAIT_L
#undef PG8_BAR
#undef PG8_SCHED
#undef PG8_VOFF
}

struct EpiBf16 {
    static constexpr bool PERM = true, MIDK = false;
    bf16_t* O; int ldc;
    __device__ __forceinline__ void midk(f32x4 (&)[2][2][4][2], const Unit&, int, int) const {}
    __device__ __forceinline__ void operator()(const f32x4 (&acc)[2][2][4][2], const Unit& u, int wr, int wc, int fr, int fq) const {
        const int row0 = u.pm * BM + wr * 64 + fr; const int col0 = u.pn * BM + wc * 32 + 8 * fq;
#pragma unroll
        for (int ai = 0; ai < 2; ++ai)
#pragma unroll
            for (int m = 0; m < 4; ++m) { bf16_t* rowp = O + (size_t)(row0 + ai * HALF + m * 16) * ldc + col0;
#pragma unroll
                for (int bj = 0; bj < 2; ++bj) { const f32x4 v0 = acc[ai][bj][m][0], v1 = acc[ai][bj][m][1];
                    u32x4 w; w.x = cvt_pk_bf16(v0[0], v0[1]); w.y = cvt_pk_bf16(v0[2], v0[3]); w.z = cvt_pk_bf16(v1[0], v1[1]); w.w = cvt_pk_bf16(v1[2], v1[3]);
                    *(u32x4*)(rowp + bj * HALF) = w; } }
    }
};
}
namespace att {
typedef short bf16x8 __attribute__((ext_vector_type(8)));
typedef short s16x4 __attribute__((ext_vector_type(4)));
typedef float f32x16 __attribute__((ext_vector_type(16)));
typedef unsigned u32x4 __attribute__((ext_vector_type(4)));
typedef unsigned u32x2 __attribute__((ext_vector_type(2)));
typedef float f32x2_t __attribute__((ext_vector_type(2)));
typedef __bf16 bf16x2_t __attribute__((ext_vector_type(2)));
typedef short v4i16_t __attribute__((ext_vector_type(4)));

constexpr int L_TILES = 0;
constexpr int L_OST = 65536, OST_PITCH = 136;
constexpr int L_MST = L_OST + 512 * OST_PITCH;
constexpr int L_LST = L_MST + 2048;
constexpr int L_RPB = L_LST + 2048;
constexpr int L_END = L_RPB + 4096;

__device__ __forceinline__ int crow(int r, int hi) { return (r & 3) + 8 * (r >> 2) + 4 * hi; }
__device__ __forceinline__ float hswap_max(float v) { auto rr = __builtin_amdgcn_permlane32_swap(__float_as_uint(v), __float_as_uint(v), false, false); return fmaxf(__uint_as_float(rr[0]), __uint_as_float(rr[1])); }
__device__ __forceinline__ float hswap_sum(float v) { auto rr = __builtin_amdgcn_permlane32_swap(__float_as_uint(v), __float_as_uint(v), false, false); return __uint_as_float(rr[0]) + __uint_as_float(rr[1]); }
__device__ __forceinline__ unsigned cvtpk(float lo, float hi) { f32x2_t v = {lo, hi}; bf16x2_t b = __builtin_convertvector(v, bf16x2_t); return __builtin_bit_cast(unsigned, b); }
__device__ __forceinline__ s16x4 vtr(LAS const char* p) { return __builtin_bit_cast(s16x4, __builtin_amdgcn_ds_read_tr16_b64_v4i16((LAS v4i16_t*)p)); }
__device__ __forceinline__ float ex2(float x) { return __builtin_amdgcn_exp2f(x); }

struct TileRegs { u32x4 k[4], v[4]; };
__device__ __forceinline__ void tile_issue(TileRegs& t, const bf16* gk, long rstride, int lane) {
    const int r0 = lane >> 3, c = lane & 7;
#pragma unroll
    for (int i = 0; i < 4; ++i) { const bf16* p = gk + (long)(r0 + 8 * i) * rstride + c * 8; t.k[i] = *(const u32x4*)p; t.v[i] = *(const u32x4*)(p + 512); }
}
__device__ __forceinline__ void tile_commit(const TileRegs& t, LAS char* kt, LAS char* vt, int lane) {
    const int r0 = lane >> 3, c = lane & 7;
#pragma unroll
    for (int i = 0; i < 4; ++i) { const int row = r0 + 8 * i;
        *(LAS u32x4*)(kt + row * 128 + ((c ^ ((row >> 1) & 7)) << 4)) = t.k[i];
        *(LAS u32x4*)(vt + row * 128 + ((((c >> 2) ^ ((row >> 1) & 1))) << 6) + ((c & 3) << 4)) = t.v[i]; }
}
template <class BiasF>
__device__ __forceinline__ void tile_compute(LAS const char* kt, LAS const char* vt, const bf16x8 (&qf)[4], f32x16 (&o)[2], float& m, float& l, const BiasF& bias, int lane) {
    const int r = lane & 31, hh = lane >> 5;
    f32x16 s;
#pragma unroll
    for (int i = 0; i < 16; ++i) s[i] = 0.f;
#pragma unroll
    for (int d0 = 0; d0 < 4; ++d0) { const bf16x8 kf = *(LAS const bf16x8*)(kt + r * 128 + ((((2 * d0 + hh) ^ ((r >> 1) & 7))) << 4)); s = __builtin_amdgcn_mfma_f32_32x32x16_bf16(kf, qf[d0], s, 0, 0, 0); }
    bias(s);
    float mx = s[0];
#pragma unroll
    for (int i = 1; i < 16; ++i) mx = fmaxf(mx, s[i]);
    mx = hswap_max(mx);
    const float mn = fmaxf(m, mx), alpha = ex2(m - mn); m = mn;
    float ps = 0.f;
#pragma unroll
    for (int i = 0; i < 16; ++i) { s[i] = ex2(s[i] - mn); ps += s[i]; }
    l = l * alpha + ps;
#pragma unroll
    for (int db = 0; db < 2; ++db)
#pragma unroll
        for (int i = 0; i < 16; ++i) o[db][i] *= alpha;
    bf16x8 pf[2];
#pragma unroll
    for (int sx = 0; sx < 2; ++sx) { u32x4 w; w.x = cvtpk(s[8 * sx], s[8 * sx + 1]); w.y = cvtpk(s[8 * sx + 2], s[8 * sx + 3]); w.z = cvtpk(s[8 * sx + 4], s[8 * sx + 5]); w.w = cvtpk(s[8 * sx + 6], s[8 * sx + 7]); pf[sx] = __builtin_bit_cast(bf16x8, w); }
    const int i16 = lane & 15, q = i16 >> 2, p = i16 & 3, cblk = (lane >> 4) & 1, sw = (q >> 1) & 1;
#pragma unroll
    for (int db = 0; db < 2; ++db) { LAS const char* vb = vt + (4 * hh + q) * 128 + ((db ^ sw) << 6) + cblk * 32 + p * 8;
#pragma unroll
        for (int sx = 0; sx < 2; ++sx) { const s16x4 lo = vtr(vb + sx * 2048), hi = vtr(vb + sx * 2048 + 1024);
            const bf16x8 vf = __builtin_shufflevector(lo, hi, 0, 1, 2, 3, 4, 5, 6, 7);
            o[db] = __builtin_amdgcn_mfma_f32_32x32x16_bf16(vf, pf[sx], o[db], 0, 0, 0); } }
}

struct DilBias {
    float slope2, toff; int i, hh;
    __device__ __forceinline__ void operator()(f32x16& s) const {
#pragma unroll
        for (int r = 0; r < 16; ++r) { const float off = fabsf((float)(crow(r, hh) - i) + toff); const float v = s[r] - slope2 * off; s[r] = (off <= 64.f) ? v : -INFINITY; }
    }
};
struct NaBias {
    LAS const float* tb; float rowterm; const float (&cm)[16]; int hh;
    __device__ __forceinline__ void operator()(f32x16& s) const {
#pragma unroll
        for (int r = 0; r < 16; ++r) s[r] = s[r] + tb[crow(r, hh)] + (cm[r] + rowterm);
    }
};

__device__ __forceinline__ void dil_task(const bf16* QKV, bf16* Y, float* SS, LAS char* lds, int b, int h, int T0, int p, int r, int j, int wave, int lane) {
    const int sh = 2 * p, d = 1 << sh, L = S >> sh;
    const int i = lane & 31, hh = lane >> 5;
    const int lq0 = (T0 >> sh) + 32 * j;
    const int tokq = (lq0 + i) * d + r;
    const bf16* qrow = QKV + (size_t)(b * S + tokq) * NQKV + h * 64 + 8 * hh;
    bf16x8 qf[4];
#pragma unroll
    for (int d0 = 0; d0 < 4; ++d0) qf[d0] = *(const bf16x8*)(qrow + 16 * d0);
    f32x16 o[2];
#pragma unroll
    for (int db = 0; db < 2; ++db)
#pragma unroll
        for (int x = 0; x < 16; ++x) o[db][x] = 0.f;
    float m = -1e30f, l = 0.f;
    const int lqb = lq0 >> 5;
    const int kt_lo = (2 - lqb) > 0 ? (2 - lqb) : 0, kt_hi = (((L - lq0) >> 5) + 1) < 4 ? (((L - lq0) >> 5) + 1) : 4;
    const bf16* kbase = QKV + (size_t)(b * S + r) * NQKV + 512 + h * 64;
    const long rstride = (long)d * NQKV;
    LAS char* kt_l = lds + L_TILES + wave * 8192; LAS char* vt_l = kt_l + 4096;
    DilBias bias; bias.slope2 = exp2f(-(float)(h + 1)) * LOG2E * (float)d; bias.i = i; bias.hh = hh; bias.toff = 0.f;
    TileRegs tr;
    tile_issue(tr, kbase + (long)(lq0 - 64 + 32 * kt_lo) * rstride, rstride, lane);
    for (int kt = kt_lo; kt <= kt_hi; ++kt) {
        tile_commit(tr, kt_l, vt_l, lane);
        if (kt < kt_hi) tile_issue(tr, kbase + (long)(lq0 - 64 + 32 * (kt + 1)) * rstride, rstride, lane);
        bias.toff = (float)(32 * kt - 64);
        tile_compute(kt_l, vt_l, qf, o, m, l, bias, lane);
    }
    float lt = hswap_sum(l);
    const int tl = tokq - T0;
    LAS char* orow = lds + L_OST + tl * OST_PITCH + 8 * hh;
    LAS float* mst = (LAS float*)(lds + L_MST); LAS float* lst = (LAS float*)(lds + L_LST);
    if (p > 0) {
        const float ms = mst[tl], ls = lst[tl];
        const float mn = fmaxf(m, ms), a = ex2(m - mn), bs = ex2(ms - mn);
#pragma unroll
        for (int db = 0; db < 2; ++db)
#pragma unroll
            for (int g = 0; g < 4; ++g) { const u32x2 w = *(LAS const u32x2*)(orow + db * 64 + g * 16);
                o[db][4 * g + 0] = o[db][4 * g + 0] * a + bflo(w.x) * bs; o[db][4 * g + 1] = o[db][4 * g + 1] * a + bfhi(w.x) * bs;
                o[db][4 * g + 2] = o[db][4 * g + 2] * a + bflo(w.y) * bs; o[db][4 * g + 3] = o[db][4 * g + 3] * a + bfhi(w.y) * bs; }
        lt = lt * a + ls * bs; m = mn;
    }
    if (p < 2) {
#pragma unroll
        for (int db = 0; db < 2; ++db)
#pragma unroll
            for (int g = 0; g < 4; ++g) { u32x2 w; w.x = cvtpk(o[db][4 * g], o[db][4 * g + 1]); w.y = cvtpk(o[db][4 * g + 2], o[db][4 * g + 3]); *(LAS u32x2*)(orow + db * 64 + g * 16) = w; }
        if (hh == 0) { mst[tl] = m; lst[tl] = lt; }
    } else {
        const float inv = 1.f / lt; float ss = 0.f;
        bf16* yrow = Y + (size_t)(b * S + tokq) * 1024 + h * 64 + 4 * hh;
#pragma unroll
        for (int db = 0; db < 2; ++db)
#pragma unroll
            for (int g = 0; g < 4; ++g) { const float v0 = o[db][4 * g] * inv, v1 = o[db][4 * g + 1] * inv, v2 = o[db][4 * g + 2] * inv, v3 = o[db][4 * g + 3] * inv;
                ss += (v0 * v0 + v1 * v1) + (v2 * v2 + v3 * v3);
                u32x2 w; w.x = cvtpk(v0, v1); w.y = cvtpk(v2, v3); *(u32x2*)(yrow + db * 32 + g * 8) = w; }
        ss = hswap_sum(ss);
        if (hh == 0) SS[(size_t)(b * S + tokq) * 16 + h] = ss;
    }
}

__device__ __forceinline__ void na_task(const bf16* QKV, bf16* Y, float* SS, LAS char* lds, int b, int h, int rp, int cb, int wave, int lane) {
    const int i = lane & 31, hh = lane >> 5;
    const int qr = 2 * rp + (i >> 4), qc = 16 * cb + (i & 15), tokq = qr * 64 + qc;
    const bf16* qrow = QKV + (size_t)(b * S + tokq) * NQKV + 1536 + h * 64 + 8 * hh;
    bf16x8 qf[4];
#pragma unroll
    for (int d0 = 0; d0 < 4; ++d0) qf[d0] = *(const bf16x8*)(qrow + 16 * d0);
    f32x16 o[2];
#pragma unroll
    for (int db = 0; db < 2; ++db)
#pragma unroll
        for (int x = 0; x < 16; ++x) o[db][x] = 0.f;
    float m = -1e30f, l = 0.f;
    const int kc0 = min(max(16 * cb - 8, 0), 32);
    const int kr_lo = min(max(2 * rp - 4, 0), 24), kr_hi = min(max(2 * rp - 3, 0), 24) + 7;
    const int cs = min(max(qc - 8, 0), 48), rs = min(max(qr - 4, 0), 24);
    float cm[16];
#pragma unroll
    for (int r = 0; r < 16; ++r) { const unsigned t = (unsigned)(kc0 + crow(r, hh) - cs); cm[r] = (t < 16u) ? 0.f : -INFINITY; }
    const bf16* kbase = QKV + (size_t)(b * S + kc0) * NQKV + 1536 + 512 + h * 64;
    LAS char* kt_l = lds + L_TILES + wave * 8192; LAS char* vt_l = kt_l + 4096;
    LAS const float* tb0 = (LAS const float*)(lds + L_RPB) + (7 - qr) * 64 + (kc0 - qc + 15 + 16);
    TileRegs tr;
    tile_issue(tr, kbase + (long)kr_lo * 64 * NQKV, NQKV, lane);
    for (int kr = kr_lo; kr <= kr_hi; ++kr) {
        tile_commit(tr, kt_l, vt_l, lane);
        if (kr < kr_hi) tile_issue(tr, kbase + (long)(kr + 1) * 64 * NQKV, NQKV, lane);
        const NaBias bias{tb0 + kr * 64, ((unsigned)(kr - rs) < 8u) ? 0.f : -INFINITY, cm, hh};
        tile_compute(kt_l, vt_l, qf, o, m, l, bias, lane);
    }
    const float lt = hswap_sum(l);
    const float inv = 1.f / lt; float ss = 0.f;
    bf16* yrow = Y + (size_t)(b * S + tokq) * 1024 + 512 + h * 64 + 4 * hh;
#pragma unroll
    for (int db = 0; db < 2; ++db)
#pragma unroll
        for (int g = 0; g < 4; ++g) { const float v0 = o[db][4 * g] * inv, v1 = o[db][4 * g + 1] * inv, v2 = o[db][4 * g + 2] * inv, v3 = o[db][4 * g + 3] * inv;
            ss += (v0 * v0 + v1 * v1) + (v2 * v2 + v3 * v3);
            u32x2 w; w.x = cvtpk(v0, v1); w.y = cvtpk(v2, v3); *(u32x2*)(yrow + db * 32 + g * 8) = w; }
    ss = hswap_sum(ss);
    if (hh == 0) SS[(size_t)(b * S + tokq) * 16 + 8 + h] = ss;
}

__device__ __forceinline__ void attn_phase(const bf16* QKV, bf16* Y, float* SS, const float* rpb, LAS char* lds, int vcu, int G, int tid) {
    const int wave = __builtin_amdgcn_readfirstlane(tid >> 6), lane = tid & 63;
    for (int u = vcu; u < 512; u += G) {
        const int bh = u >> 2, b = bh >> 3, h = bh & 7, T0 = (u & 3) * 512;
        for (int p = 0; p < 3; ++p) {
            const int d = 1 << (2 * p);
            for (int n = 0; n < 2; ++n) { const int task = wave + 8 * n; dil_task(QKV, Y, SS, lds, b, h, T0, p, task & (d - 1), task >> (2 * p), wave, lane); }
            __syncthreads();
        }
    }
    for (int u = vcu; u < 512; u += G) {
        const int bh = u >> 2, b = bh >> 3, h = bh & 7, R8 = u & 3;
        __syncthreads();
        for (int idx = tid; idx < 1024; idx += 512) { const int dr = idx >> 6, dc = (idx & 63) - 16;
            ((LAS float*)(lds + L_RPB))[idx] = (dr < 15 && dc >= 0 && dc < 31) ? rpb[(h * 15 + dr) * 31 + dc] * LOG2E : 0.f; }
        __syncthreads();
        for (int n = 0; n < 2; ++n) { const int task = wave + 8 * n; na_task(QKV, Y, SS, lds, b, h, 4 * R8 + (task >> 2), task & 3, wave, lane); }
    }
    __syncthreads();
}
}
namespace pg8 {
struct EpiOutProj {
    static constexpr bool PERM = false, MIDK = true;
    const float* x; float* H; PG8_LAS const f32x2* tab;
    __device__ __forceinline__ void midk(f32x4 (&acc)[2][2][4][2], const Unit& u, int wr, int fr) const {
#pragma unroll
        for (int ai = 0; ai < 2; ++ai)
#pragma unroll
            for (int m = 0; m < 4; ++m) { const float r = tab[u.ord * BM + ai * HALF + wr * 64 + m * 16 + fr].x;
#pragma unroll
                for (int bj = 0; bj < 2; ++bj)
#pragma unroll
                    for (int n = 0; n < 2; ++n) acc[ai][bj][m][n] = acc[ai][bj][m][n] * r; }
    }
    __device__ __forceinline__ void operator()(const f32x4 (&acc)[2][2][4][2], const Unit& u, int wr, int wc, int fr, int fq) const {
        const int col0 = u.pn * BM + wc * 32 + 4 * fq;
#pragma unroll
        for (int ai = 0; ai < 2; ++ai)
#pragma unroll
            for (int m = 0; m < 4; ++m) { const int r = ai * HALF + wr * 64 + m * 16 + fr; const float s = tab[u.ord * BM + r].y; const size_t off = (size_t)(u.pm * BM + r) * 1024 + col0;
#pragma unroll
                for (int bj = 0; bj < 2; ++bj)
#pragma unroll
                    for (int n = 0; n < 2; ++n) { const f32x4 xv = *(const f32x4*)(x + off + bj * HALF + n * 16); *(f32x4*)(H + off + bj * HALF + n * 16) = xv + acc[ai][bj][m][n] * s; } }
    }
};

struct MoeOrder {
    const unsigned* cnt; const int* perm; const char* A; const char* Bt; int K; int G, vcu; bool down;
    __device__ bool next(int i, Unit& u) const {
        const int L = i * G + vcu, rt = L >> 2; int accv = 0;
        for (int c = 0; c < NCLS; ++c) { const int n = (int)cnt[c], tiles = (n + 255) >> 8;
            if (rt < accv + tiles) { u.cls = c; u.pm = rt - accv; u.pn = L & 3; u.ord = i; u.slot0 = rt * BM; const int rem = n - (rt - accv) * BM; u.nvalid = rem < BM ? rem : BM; return true; }
            accv += tiles; }
        return false;
    }
    __device__ __forceinline__ static int expert_of(int cls, int second) { const int g = cls / 6, idx = cls % 6; const int lo = idx < 3 ? 0 : (idx < 5 ? 1 : 2), hi = idx < 3 ? idx + 1 : (idx < 5 ? idx - 1 : 3); return 4 * g + (second ? hi : lo); }
    __device__ __forceinline__ const char* a_base(const Unit& u) const { return down ? A + (size_t)u.slot0 * K * 2 : A; }
    __device__ __forceinline__ const char* b_base(const Unit& u) const {
        if (down) return Bt + ((size_t)u.cls * 1024 + (size_t)u.pn * BM) * K * 2;
        return Bt + ((size_t)expert_of(u.cls, u.pn >> 1) * 512 + (size_t)(u.pn & 1) * BM) * K * 2;
    }
    __device__ __forceinline__ int token_of(const Unit& u, int r) const { const int rr = r < u.nvalid ? r : u.nvalid - 1; return perm[(size_t)u.cls * M + u.pm * BM + rr]; }
};
struct MoeOrderUp : MoeOrder { static constexpr bool GATHER = true; __device__ __forceinline__ int gather_row(const Unit& u, int r) const { return token_of(u, r); } };
struct MoeOrderDown : MoeOrder { static constexpr bool GATHER = false; __device__ __forceinline__ int gather_row(const Unit&, int r) const { return r; } };

struct EpiSwiglu {
    static constexpr bool PERM = true, MIDK = false;
    bf16_t* HID; const float* route; const MoeOrderUp* S;
    __device__ __forceinline__ void midk(f32x4 (&)[2][2][4][2], const Unit&, int, int) const {}
    __device__ __forceinline__ void operator()(const f32x4 (&acc)[2][2][4][2], const Unit& u, int wr, int wc, int fr, int fq) const {
        const int col0 = u.pn * HALF + wc * 32 + 8 * fq;
#pragma unroll
        for (int ai = 0; ai < 2; ++ai)
#pragma unroll
            for (int m = 0; m < 4; ++m) { const int r = ai * HALF + wr * 64 + m * 16 + fr; const int tok = S->token_of(u, r);
                const float w = route[(size_t)tok * 4 + 2 + (u.pn >> 1)];
                float a[8];
#pragma unroll
                for (int n = 0; n < 2; ++n)
#pragma unroll
                    for (int e = 0; e < 4; ++e) { const float g = acc[ai][0][m][n][e], up = acc[ai][1][m][n][e]; a[4 * n + e] = g * __builtin_amdgcn_rcpf(1.f + __builtin_amdgcn_exp2f(-g * LOG2E)) * up * w; }
                u32x4 o; o.x = cvt_pk_bf16(a[0], a[1]); o.y = cvt_pk_bf16(a[2], a[3]); o.z = cvt_pk_bf16(a[4], a[5]); o.w = cvt_pk_bf16(a[6], a[7]);
                *(u32x4*)(HID + (size_t)(u.slot0 + r) * 512 + col0) = o; }
    }
};
struct EpiDown {
    static constexpr bool PERM = false, MIDK = false;
    float* out; float* SSF; const MoeOrderDown* S;
    __device__ __forceinline__ void midk(f32x4 (&)[2][2][4][2], const Unit&, int, int) const {}
    __device__ __forceinline__ void operator()(const f32x4 (&acc)[2][2][4][2], const Unit& u, int wr, int wc, int fr, int fq) const {
        const int col0 = u.pn * BM + wc * 32 + 4 * fq;
#pragma unroll
        for (int ai = 0; ai < 2; ++ai)
#pragma unroll
            for (int m = 0; m < 4; ++m) { const int r = ai * HALF + wr * 64 + m * 16 + fr; const bool ok = r < u.nvalid; const int tok = S->token_of(u, r);
                const size_t off = (size_t)tok * 1024 + col0; float ss = 0.f;
#pragma unroll
                for (int bj = 0; bj < 2; ++bj)
#pragma unroll
                    for (int n = 0; n < 2; ++n) { f32x4 v = *(const f32x4*)(out + off + bj * HALF + n * 16); v = v + acc[ai][bj][m][n];
                        ss += (v[0] * v[0] + v[1] * v[1]) + (v[2] * v[2] + v[3] * v[3]); if (ok) *(f32x4*)(out + off + bj * HALF + n * 16) = v; }
                ss += __shfl_xor(ss, 16); ss += __shfl_xor(ss, 32);
                if (ok && fq == 0) SSF[(size_t)tok * 16 + u.pn * 4 + wc] = ss; }
    }
};
}

__device__ __forceinline__ void transpose_item(const float* W, int ldn, int k0, int n0, bf16* dst, int ldk, int drow0, int dcol0, const float* gk, float csc, LAS float* scr, int lane) {
#pragma unroll 8
    for (int i = 0; i < 32; ++i) { const int kk = 2 * i + (lane >> 5); const float sc = (gk ? gk[k0 + kk] : 1.f) * csc; scr[kk * 33 + (lane & 31)] = W[(size_t)(k0 + kk) * ldn + n0 + (lane & 31)] * sc; }
    asm volatile("s_waitcnt lgkmcnt(0)" ::: "memory");
    const int c = lane & 7;
#pragma unroll
    for (int j = 0; j < 4; ++j) { const int n = (lane >> 3) + 8 * j; const LAS float* s = scr + (8 * c) * 33 + n;
        v4u o; o.x = pk2(s[0 * 33], s[1 * 33]); o.y = pk2(s[2 * 33], s[3 * 33]); o.z = pk2(s[4 * 33], s[5 * 33]); o.w = pk2(s[6 * 33], s[7 * 33]);
        *(v4u*)(dst + (size_t)(drow0 + n) * ldk + dcol0 + k0 + 8 * c) = o; }
    asm volatile("s_waitcnt lgkmcnt(0)" ::: "memory");
}

struct Ptrs {
    const float *x, *norm_mix_g, *w_in, *rpb, *g_out_dil, *g_out_na, *w_out, *norm_ffn_g, *w_group, *b_group, *w_router, *b_router, *w_gate, *w_up, *w_down, *norm_final_g;
    float* out; unsigned char* ws;
};

__device__ __forceinline__ void prologue_phase(const Ptrs& P, LAS unsigned char* lds, int vcu, int G, int tid) {
    const int wave = __builtin_amdgcn_readfirstlane(tid >> 6), lane = tid & 63;
    LAS float* scr = (LAS float*)(lds + wave * 16384);
    const int gw = vcu * 8 + wave, NGW = G * 8;
    bf16* Win_t = (bf16*)(P.ws + WS_WIN); bf16* Wout_t = (bf16*)(P.ws + WS_WOUT); bf16* Wgu_t = (bf16*)(P.ws + WS_WGU); bf16* Wdp = (bf16*)(P.ws + WS_WDP);
    constexpr int I_IN = 16 * 96, I_OUT = 16 * 32, I_GU = 16 * 256, I_DP = 48 * 128, NITEMS = I_IN + I_OUT + I_GU + I_DP;
    for (int it = gw; it < NITEMS; it += NGW) {
        int r = it;
        if (r < I_IN) { const int kb = r / 96, nb = r % 96, n0 = 32 * nb; const bool isq = (n0 < 512) || (n0 >= 1536 && n0 < 2048);
            transpose_item(P.w_in, NQKV, 64 * kb, n0, Win_t, 1024, n0, 0, nullptr, isq ? QSCALE : 1.f, scr, lane); continue; }
        r -= I_IN;
        if (r < I_OUT) { const int kb = r / 32, nb = r % 32, k0 = 64 * kb; const float* gk = (k0 < 512) ? P.g_out_dil : (P.g_out_na - 512);
            transpose_item(P.w_out, 1024, k0, 32 * nb, Wout_t, 1024, 32 * nb, 0, gk, 1.f, scr, lane); continue; }
        r -= I_OUT;
        if (r < I_GU) { const int e = r >> 8, q = r & 255, isup = q >> 7, kb = (q & 127) >> 3, nb = q & 7, n0 = 32 * nb;
            const float* src = (isup ? P.w_up : P.w_gate) + (size_t)e * 1024 * 256;
            transpose_item(src, 256, 64 * kb, n0, Wgu_t + (size_t)e * 512 * 1024, 1024, (n0 >> 7) * 256 + (n0 & 127) + isup * 128, 0, nullptr, 1.f, scr, lane); continue; }
        r -= I_GU;
        { const int ch = r >> 7, q = r & 127, cls = ch >> 1, hf = ch & 1, kb = q >> 5, nb = q & 31; const int e = pg8::MoeOrder::expert_of(cls, hf);
            transpose_item(P.w_down + (size_t)e * 256 * 1024, 1024, 64 * kb, 32 * nb, Wdp + (size_t)cls * 1024 * 512, 512, 32 * nb, hf * 256, nullptr, 1.f, scr, lane); }
    }
    bf16* XN = (bf16*)(P.ws + WS_XN);
    f32x4 gv[4];
#pragma unroll
    for (int j = 0; j < 4; ++j) gv[j] = *((const f32x4*)P.norm_mix_g + lane + 64 * j);
    for (int row = gw; row < M; row += NGW) {
        const f32x4* xr = (const f32x4*)(P.x + (size_t)row * 1024) + lane; f32x4 v[4]; float s = 0.f;
#pragma unroll
        for (int j = 0; j < 4; ++j) { v[j] = xr[64 * j]; s += (v[j].x * v[j].x + v[j].y * v[j].y) + (v[j].z * v[j].z + v[j].w * v[j].w); }
        const float rs = rsqrtf(wave_sum(s) * (1.f / 1024.f) + EPS);
        v2u* o8 = (v2u*)(XN + (size_t)row * 1024) + lane;
#pragma unroll
        for (int j = 0; j < 4; ++j) { v2u w; w.x = pk2(v[j].x * rs * gv[j].x, v[j].y * rs * gv[j].y); w.y = pk2(v[j].z * rs * gv[j].z, v[j].w * rs * gv[j].w); o8[64 * j] = w; }
    }
}

constexpr int RT_WR = 0;
constexpr int RT_CNT = 81920;
constexpr int RT_LIST = 81920 + 256;
__device__ __forceinline__ void router_phase(const Ptrs& P, LAS unsigned char* lds, int vcu, int G, int tid) {
    const int wave = __builtin_amdgcn_readfirstlane(tid >> 6), lane = tid & 63;
    LAS float* Wr = (LAS float*)(lds + RT_WR); LAS int* lcnt = (LAS int*)(lds + RT_CNT); LAS int* lbase = lcnt + 32; LAS int* lcls = (LAS int*)(lds + RT_LIST); LAS int* lpos = lcls + 128;
    const float* H = P.out; bf16* XN2 = (bf16*)(P.ws + WS_XN); float* route = (float*)(P.ws + WS_ROUTE); int* perm = (int*)(P.ws + WS_PERM); unsigned* cnt = (unsigned*)(P.ws + WS_CTL) + CW_CNT;
#pragma unroll 4
    for (int idx = tid; idx < 20 * 1024; idx += 512) { const int o = idx >> 10, k = idx & 1023; Wr[idx] = (o < 4) ? P.w_group[k * 4 + o] : P.w_router[k * 16 + (o - 4)]; }
    f32x4 gv[4];
#pragma unroll
    for (int j = 0; j < 4; ++j) gv[j] = *((const f32x4*)P.norm_ffn_g + lane + 64 * j);
    for (int blk = vcu; blk < M / 128; blk += G) {
        __syncthreads();
        if (tid < 32) lcnt[tid] = 0;
        __syncthreads();
#pragma unroll 1
        for (int grp = 0; grp < 8; ++grp) {
            const int tl0 = wave * 16 + grp * 2, tok0 = blk * 128 + tl0;
            f32x4 v[2][4];
#pragma unroll
            for (int t = 0; t < 2; ++t) { const f32x4* hr = (const f32x4*)(H + (size_t)(tok0 + t) * 1024) + lane; float s = 0.f;
#pragma unroll
                for (int j = 0; j < 4; ++j) { v[t][j] = hr[64 * j]; s += (v[t][j].x * v[t][j].x + v[t][j].y * v[t][j].y) + (v[t][j].z * v[t][j].z + v[t][j].w * v[t][j].w); }
                const float rs = rsqrtf(wave_sum(s) * (1.f / 1024.f) + EPS);
                v2u* o8 = (v2u*)(XN2 + (size_t)(tok0 + t) * 1024) + lane;
#pragma unroll
                for (int j = 0; j < 4; ++j) { v[t][j] = v[t][j] * rs * gv[j]; v2u w; w.x = pk2(v[t][j].x, v[t][j].y); w.y = pk2(v[t][j].z, v[t][j].w); o8[64 * j] = w; } }
            float lg[2][20];
#pragma unroll
            for (int o = 0; o < 20; ++o) {
                f32x4 w[4];
#pragma unroll
                for (int j = 0; j < 4; ++j) w[j] = *((LAS const f32x4*)(Wr + o * 1024) + lane + 64 * j);
#pragma unroll
                for (int t = 0; t < 2; ++t) { float s = 0.f;
#pragma unroll
                    for (int j = 0; j < 4; ++j) s += (v[t][j].x * w[j].x + v[t][j].y * w[j].y) + (v[t][j].z * w[j].z + v[t][j].w * w[j].w);
                    lg[t][o] = __builtin_bit_cast(float, __builtin_amdgcn_readfirstlane(__builtin_bit_cast(int, wave_sum(s)))) + ((o < 4) ? P.b_group[o] : P.b_router[o - 4]); }
                asm volatile("" ::: "memory");
            }
#pragma unroll
            for (int t = 0; t < 2; ++t) {
                int g = 0; float gm = lg[t][0];
#pragma unroll
                for (int i = 1; i < 4; ++i) if (lg[t][i] > gm) { gm = lg[t][i]; g = i; }
                float gs = 0.f;
#pragma unroll
                for (int i = 0; i < 4; ++i) gs += __expf(lg[t][i] - gm);
                const float gw = 1.f / gs;
                float e[4];
#pragma unroll
                for (int i = 0; i < 4; ++i) { e[i] = lg[t][4 + i];
#pragma unroll
                    for (int gg = 1; gg < 4; ++gg) if (g == gg) e[i] = lg[t][4 + gg * 4 + i]; }
                int i1 = 0; float v1 = e[0];
#pragma unroll
                for (int i = 1; i < 4; ++i) if (e[i] > v1) { v1 = e[i]; i1 = i; }
                int i2 = -1; float v2 = -3e38f;
#pragma unroll
                for (int i = 0; i < 4; ++i) if (i != i1 && e[i] > v2) { v2 = e[i]; i2 = i; }
                const float p1 = 1.f / (1.f + __expf(v2 - v1)), p2 = 1.f - p1;
                const int lo = i1 < i2 ? i1 : i2, hi = i1 < i2 ? i2 : i1; const float wlo = (i1 < i2 ? p1 : p2) * gw, whi = (i1 < i2 ? p2 : p1) * gw;
                const int pidx = (lo == 0) ? (hi - 1) : (lo == 1 ? hi + 1 : 5); const int cls = g * 6 + pidx;
                if (lane == 0) { f32x4 r; r.x = (float)(g * 4 + lo); r.y = (float)(g * 4 + hi); r.z = wlo; r.w = whi; *(f32x4*)(route + (size_t)(tok0 + t) * 4) = r;
                    lcls[tl0 + t] = cls; lpos[tl0 + t] = __hip_atomic_fetch_add(lcnt + cls, 1, __ATOMIC_RELAXED, __HIP_MEMORY_SCOPE_WORKGROUP); }
            }
        }
        __syncthreads();
        if (tid < NCLS) lbase[tid] = (int)__hip_atomic_fetch_add(cnt + tid, (unsigned)lcnt[tid], __ATOMIC_RELAXED, __HIP_MEMORY_SCOPE_AGENT);
        __syncthreads();
        if (tid < 128) { const int c = lcls[tid]; perm[(size_t)c * M + lbase[c] + lpos[tid]] = blk * 128 + tid; }
    }
}

__device__ __forceinline__ void final_phase(const Ptrs& P, int vcu, int G, int tid) {
    const int wave = __builtin_amdgcn_readfirstlane(tid >> 6), lane = tid & 63; const int gw = vcu * 8 + wave, NGW = G * 8;
    const float* SSF = (const float*)(P.ws + WS_SSF);
    f32x4 gv[4];
#pragma unroll
    for (int j = 0; j < 4; ++j) gv[j] = *((const f32x4*)P.norm_final_g + lane + 64 * j);
    for (int row = gw; row < M; row += NGW) {
        const f32x4* sp = (const f32x4*)(SSF + (size_t)row * 16); const f32x4 a = sp[0], b = sp[1], c = sp[2], d = sp[3];
        const float ss = ((a.x + a.y) + (a.z + a.w)) + ((b.x + b.y) + (b.z + b.w)) + ((c.x + c.y) + (c.z + c.w)) + ((d.x + d.y) + (d.z + d.w));
        const float rs = rsqrtf(ss * (1.f / 1024.f) + EPS);
        f32x4* orow = (f32x4*)(P.out + (size_t)row * 1024) + lane;
#pragma unroll
        for (int j = 0; j < 4; ++j) { const f32x4 v = orow[64 * j]; orow[64 * j] = v * rs * gv[j]; }
    }
}
#define XB_TMO      128
#define XB_XCNT(j)  (256  + 64 * (j))
#define XB_XSUB(j)  (1280 + 64 * (j))
#define XB_XGEN(j)  (2304 + 64 * (j))
#define XB_TOP      3328
#define XB_TOPGEN   3392
#define XCD_BAR_WORDS 3456
#define XB_SPIN_CAP (1u << 18)

__device__ __forceinline__ unsigned xb_ld(unsigned* p)              { return __hip_atomic_load(p, __ATOMIC_RELAXED, __HIP_MEMORY_SCOPE_AGENT); }
__device__ __forceinline__ unsigned xb_add(unsigned* p, unsigned v) { return __hip_atomic_fetch_add(p, v, __ATOMIC_RELAXED, __HIP_MEMORY_SCOPE_AGENT); }
__device__ __forceinline__ unsigned xb_xcc_id() { return (unsigned)__builtin_amdgcn_s_getreg((3 << 11) | 20) & 0xFu; }
#define XB_SPIN(cond, bar) do { unsigned _sp = 0; while (cond) { __builtin_amdgcn_s_sleep(1); \
    if ((++_sp & 255u) == 0u) { if (xb_ld(&(bar)[XB_TMO])) break; if (_sp > XB_SPIN_CAP) { atomicAdd(&(bar)[XB_TMO], 1u); break; } } } } while (0)

struct XcdBarrier {
    unsigned* bar; unsigned x;
    volatile LAS unsigned* st;
};

__device__ __forceinline__ XcdBarrier xcd_barrier_post(unsigned* bar, volatile LAS unsigned* st) {
    XcdBarrier b; b.bar = bar; b.x = xb_xcc_id(); b.st = st;
    if (threadIdx.x == 0) (void)xb_add(&bar[XB_XCNT(b.x)], 1u);
    return b;
}
__device__ __forceinline__ void xcd_barrier_complete(unsigned* bar, unsigned x, unsigned& nloc, unsigned& nx) {
    const unsigned G = gridDim.x * gridDim.y * gridDim.z;
    unsigned sum, cnt, mine, sp = 0u;
    for (;;) {
        sum = 0u; cnt = 0u; mine = 0u;
#pragma unroll
        for (unsigned j = 0; j < 16; ++j) { const unsigned c = xb_ld(&bar[XB_XCNT(j)]); sum += c; cnt += (c > 0u) ? 1u : 0u; mine = (j == x) ? c : mine; }
        if (sum == G) break;
        __builtin_amdgcn_s_sleep(1);
        if ((++sp & 255u) == 0u) { if (xb_ld(&bar[XB_TMO])) break; if (sp > XB_SPIN_CAP) { atomicAdd(&bar[XB_TMO], 1u); break; } }
    }
    nloc = mine > 0u ? mine : 1u; nx = cnt > 0u ? cnt : 1u;
}

__device__ __forceinline__ void xcd_barrier(const XcdBarrier& b) {
    asm volatile("s_waitcnt vmcnt(0)" ::: "memory");
    __syncthreads();
    if (threadIdx.x == 0) {
        unsigned* bar = b.bar;
        __builtin_amdgcn_s_waitcnt(0);
        unsigned nloc = b.st[0], nx = b.st[1];
        if (nloc == 0u) { xcd_barrier_complete(bar, b.x, nloc, nx); b.st[0] = nloc; b.st[1] = nx; }
        const unsigned old = xb_add(&bar[XB_XSUB(b.x)], 1u);
        const unsigned gen = old / nloc;
        if (old + 1u == (gen + 1u) * nloc) {
            __builtin_amdgcn_fence(__ATOMIC_RELEASE, "agent");
            asm volatile("s_waitcnt vmcnt(0)" ::: "memory");
            const unsigned og = xb_add(&bar[XB_TOP], 1u);
            const unsigned tg = og / nx;
            if (og + 1u == (tg + 1u) * nx) xb_add(&bar[XB_TOPGEN], 1u);
            else XB_SPIN(xb_ld(&bar[XB_TOPGEN]) == tg, bar);
            __builtin_amdgcn_fence(__ATOMIC_ACQUIRE, "agent");
            xb_add(&bar[XB_XGEN(b.x)], 1u);
            asm volatile("s_waitcnt vmcnt(0)" ::: "memory");
        } else {
            XB_SPIN(xb_ld(&bar[XB_XGEN(b.x)]) == gen, bar);
            __builtin_amdgcn_fence(__ATOMIC_ACQUIRE, "agent");
            asm volatile("s_waitcnt vmcnt(0)" ::: "memory");
        }
    }
    __syncthreads();
}
constexpr int LDS_BYTES = 147456;
constexpr int LDS_TAB = 131072;
constexpr int LDSCTL_OFF = 143360, MISC_OFF = LDSCTL_OFF + 320;
constexpr int N_PHASES = 8;
static_assert(att::L_END <= LDSCTL_OFF && MISC_OFF + 128 <= LDS_BYTES, "LDS map");

struct Args { Ptrs p; int ph_lo, ph_hi; };

__global__ void __launch_bounds__(512, 2) mega_fwd(Args args) {
    extern __shared__ __attribute__((aligned(16))) unsigned char lds_raw[];
    LAS unsigned char* lds = (LAS unsigned char*)lds_raw;
    const Ptrs& P = args.p;
    const int tid = threadIdx.x, G = gridDim.x, bx = blockIdx.x;
    const int vcu = (G % 8 == 0) ? (bx % 8) * (G / 8) + bx / 8 : bx;
    for (int u = tid; u < (LDS_BYTES - LDSCTL_OFF) / 4; u += 512) ((LAS unsigned*)(lds + LDSCTL_OFF))[u] = 0u;
    __syncthreads();
    const int lo = args.ph_lo, hi = args.ph_hi;
    unsigned* ctl = (unsigned*)(P.ws + WS_CTL);
    XcdBarrier bar; bar.bar = ctl + CW_BAR; bar.x = 0; bar.st = nullptr;
    if (hi - lo > 1) bar = xcd_barrier_post(ctl + CW_BAR, (volatile LAS unsigned*)(lds + MISC_OFF) + 8);
#ifndef PHASE_MASK
#define PHASE_MASK 0xFF
#endif
#define IN(k) (((PHASE_MASK >> (k)) & 1) && lo <= (k) && (k) < hi)
#define SEAM(k) do { if (IN(k) && IN((k) + 1)) xcd_barrier(bar); } while (0)

    if (IN(0)) { prologue_phase(P, lds, vcu, G, tid); }
    SEAM(0);
    if (IN(1)) {
        pg8::StaticOrder S; S.init(P.ws + WS_XN, P.ws + WS_WIN, M, NQKV, D, G, bx);
        pg8::EpiBf16 E{(bf16*)(P.ws + WS_QKV), NQKV};
        pg8::gemm_phase<pg8::EpiBf16, pg8::StaticOrder, true>(lds, D, S, E);
    }
    SEAM(1);
    if (IN(2)) { att::attn_phase((const bf16*)(P.ws + WS_QKV), (bf16*)(P.ws + WS_Y), (float*)(P.ws + WS_SS), P.rpb, (LAS char*)lds, vcu, G, tid); }
    SEAM(2);
    if (IN(3)) {
        pg8::StaticOrder S; S.init(P.ws + WS_Y, P.ws + WS_WOUT, M, D, D, G, bx);
        LAS f32x2* tab = (LAS f32x2*)(lds + LDS_TAB);
        { const int ord = tid >> 8, r = tid & 255; pg8::Unit u;
          if (S.next(ord, u)) { const f32x4* sp = (const f32x4*)((const float*)(P.ws + WS_SS) + (size_t)(u.pm * 256 + r) * 16); const f32x4 a = sp[0], b = sp[1], c = sp[2], d = sp[3];
              const float sd = ((a.x + a.y) + (a.z + a.w)) + ((b.x + b.y) + (b.z + b.w)), sn = ((c.x + c.y) + (c.z + c.w)) + ((d.x + d.y) + (d.z + d.w));
              const float s_dil = rsqrtf(sd * (1.f / 512.f) + EPS), s_na = rsqrtf(sn * (1.f / 512.f) + EPS);
              tab[ord * 256 + r] = (f32x2){s_dil / s_na, s_na}; } }
        __syncthreads();
        pg8::EpiOutProj E{P.x, P.out, tab};
        pg8::gemm_phase<pg8::EpiOutProj, pg8::StaticOrder, true>(lds, D, S, E);
    }
    SEAM(3);
    if (IN(4)) { router_phase(P, lds, vcu, G, tid); }
    SEAM(4);
    if (IN(5)) {
        pg8::MoeOrderUp S; S.cnt = ctl + CW_CNT; S.perm = (const int*)(P.ws + WS_PERM); S.A = (const char*)(P.ws + WS_XN); S.Bt = (const char*)(P.ws + WS_WGU); S.K = D; S.G = G; S.vcu = vcu; S.down = false;
        pg8::EpiSwiglu E{(bf16*)(P.ws + WS_HID), (const float*)(P.ws + WS_ROUTE), &S};
        pg8::gemm_phase<pg8::EpiSwiglu, pg8::MoeOrderUp, true>(lds, D, S, E);
    }
    SEAM(5);
    if (IN(6)) {
        pg8::MoeOrderDown S; S.cnt = ctl + CW_CNT; S.perm = (const int*)(P.ws + WS_PERM); S.A = (const char*)(P.ws + WS_HID); S.Bt = (const char*)(P.ws + WS_WDP); S.K = 512; S.G = G; S.vcu = vcu; S.down = true;
        pg8::EpiDown E{P.out, (float*)(P.ws + WS_SSF), &S};
        pg8::gemm_phase<pg8::EpiDown, pg8::MoeOrderDown, true>(lds, 512, S, E);
    }
    SEAM(6);
    if (IN(7)) { final_phase(P, vcu, G, tid); }
#undef IN
#undef SEAM
}

template <typename T> __device__ __forceinline__ float ldf(const T* p);
template <> __device__ __forceinline__ float ldf<float>(const float* p) { return *p; }
template <> __device__ __forceinline__ float ldf<bf16>(const bf16* p) { return bf2f(*p); }

template <int NC> __global__ __launch_bounds__(256) void k_rms(const float* in, const float* g, float* out, int col0) {
    const int row = blockIdx.x * 4 + (threadIdx.x >> 6), lane = threadIdx.x & 63;
    const float* p = in + (size_t)row * 1024 + col0; float* o = out + (size_t)row * 1024 + col0;
    float v[NC / 64]; float s = 0.f;
#pragma unroll
    for (int i = 0; i < NC / 64; ++i) { v[i] = p[lane + 64 * i]; s += v[i] * v[i]; }
    s = wave_sum(s); const float r = rsqrtf(s / (float)NC + EPS);
#pragma unroll
    for (int i = 0; i < NC / 64; ++i) o[lane + 64 * i] = v[i] * r * g[lane + 64 * i];
}
__global__ __launch_bounds__(256) void k_cvt(const bf16* in, float* out) { const size_t i = (size_t)blockIdx.x * 256 + threadIdx.x; out[i] = bf2f(in[i]); }
__global__ __launch_bounds__(256) void k_gemm(const float* A, const float* Bm, float* C, const float* R, int Mm, int N, int K) {
    __shared__ float As[16][132]; __shared__ float Bs[16][132];
    const int tid = threadIdx.x, tx = tid & 15, ty = tid >> 4;
    const int m0 = blockIdx.y * 128, n0 = blockIdx.x * 128;
    float acc[8][8];
#pragma unroll
    for (int i = 0; i < 8; ++i)
#pragma unroll
        for (int j = 0; j < 8; ++j) acc[i][j] = 0.f;
    for (int k0 = 0; k0 < K; k0 += 16) {
#pragma unroll
        for (int i = 0; i < 2; ++i) {
            const int idx = tid + 256 * i, row = idx >> 2, kq = idx & 3;
            const float4 a = *(const float4*)(A + (size_t)(m0 + row) * K + k0 + kq * 4);
            As[kq * 4 + 0][row] = a.x; As[kq * 4 + 1][row] = a.y; As[kq * 4 + 2][row] = a.z; As[kq * 4 + 3][row] = a.w;
            const int kk = idx >> 5, nq = idx & 31;
            *(float4*)&Bs[kk][nq * 4] = *(const float4*)(Bm + (size_t)(k0 + kk) * N + n0 + nq * 4);
        }
        __syncthreads();
#pragma unroll
        for (int k = 0; k < 16; ++k) {
            float a[8], b[8];
#pragma unroll
            for (int i = 0; i < 8; ++i) { a[i] = As[k][ty * 8 + i]; b[i] = Bs[k][tx * 8 + i]; }
#pragma unroll
            for (int i = 0; i < 8; ++i)
#pragma unroll
                for (int j = 0; j < 8; ++j) acc[i][j] += a[i] * b[j];
        }
        __syncthreads();
    }
#pragma unroll
    for (int i = 0; i < 8; ++i)
#pragma unroll
        for (int j = 0; j < 8; ++j) { const size_t o = (size_t)(m0 + ty * 8 + i) * N + n0 + tx * 8 + j; C[o] = acc[i][j] + (R ? R[o] : 0.f); }
}
template <typename T> __global__ __launch_bounds__(256) void k_dil(const T* qkv, float* y, float qsc) {
    const int idx = blockIdx.x * 4 + (threadIdx.x >> 6), lane = threadIdx.x & 63;
    const int token = idx >> 3, h = idx & 7, b = token / S, t = token % S;
    const float slope = exp2f(-(float)(h + 1));
    const float q = ldf(qkv + (size_t)token * NQKV + h * 64 + lane) / qsc;
    float o[3], lse[3];
#pragma unroll
    for (int p = 0; p < 3; ++p) {
        const int d = (p == 0) ? 1 : (p == 1 ? 4 : 16);
        float m = -1e30f, l = 0.f, acc = 0.f;
        for (int j = -64; j <= 64; ++j) {
            const int tk = t + j * d; if (tk < 0 || tk >= S) continue;
            const size_t kr = (size_t)(b * S + tk) * NQKV + h * 64 + lane;
            const float kk = ldf(qkv + kr + 512), vv = ldf(qkv + kr + 1024);
            const float s = wave_sum(q * kk) * 0.125f - slope * (float)((j < 0 ? -j : j) * d);
            const float mn = fmaxf(m, s), sc = __expf(m - mn), pe = __expf(s - mn);
            l = l * sc + pe; acc = acc * sc + pe * vv; m = mn;
        }
        o[p] = acc / l; lse[p] = m + __logf(l);
    }
    const float mm = fmaxf(fmaxf(lse[0], lse[1]), lse[2]);
    const float w0 = __expf(lse[0] - mm), w1 = __expf(lse[1] - mm), w2 = __expf(lse[2] - mm);
    y[(size_t)token * 1024 + h * 64 + lane] = (w0 * o[0] + w1 * o[1] + w2 * o[2]) / (w0 + w1 + w2);
}
template <typename T> __global__ __launch_bounds__(256) void k_na(const T* qkv, const float* rpb, float* y, float qsc) {
    const int idx = blockIdx.x * 4 + (threadIdx.x >> 6), lane = threadIdx.x & 63;
    const int token = idx >> 3, h = idx & 7, b = token / S, t = token % S, r = t >> 6, c = t & 63;
    const int rs = min(max(r - 4, 0), 24), cs = min(max(c - 8, 0), 48);
    const float q = ldf(qkv + (size_t)token * NQKV + 1536 + h * 64 + lane) / qsc;
    float m = -1e30f, l = 0.f, acc = 0.f;
    for (int kr = rs; kr < rs + 8; ++kr)
        for (int kc = cs; kc < cs + 16; ++kc) {
            const size_t ka = (size_t)(b * S + kr * 64 + kc) * NQKV + 1536 + h * 64 + lane;
            const float kk = ldf(qkv + ka + 512), vv = ldf(qkv + ka + 1024);
            const float s = wave_sum(q * kk) * 0.125f + rpb[(h * 15 + (kr - r + 7)) * 31 + (kc - c + 15)];
            const float mn = fmaxf(m, s), sc = __expf(m - mn), pe = __expf(s - mn);
            l = l * sc + pe; acc = acc * sc + pe * vv; m = mn;
        }
    y[(size_t)token * 1024 + 512 + h * 64 + lane] = acc / l;
}
__global__ __launch_bounds__(256) void k_router(const float* hn, const float* w_group, const float* b_group, const float* w_router, const float* b_router, float* route) {
    const int token = blockIdx.x * 4 + (threadIdx.x >> 6), lane = threadIdx.x & 63;
    float v[16];
#pragma unroll
    for (int i = 0; i < 16; ++i) v[i] = hn[(size_t)token * 1024 + lane + 64 * i];
    float lg[20];
#pragma unroll
    for (int o = 0; o < 20; ++o) {
        float s = 0.f;
#pragma unroll
        for (int i = 0; i < 16; ++i) { const int k = lane + 64 * i; s += v[i] * (o < 4 ? w_group[k * 4 + o] : w_router[k * 16 + (o - 4)]); }
        lg[o] = wave_sum(s) + (o < 4 ? b_group[o] : b_router[o - 4]);
    }
    int g = 0; float gm = lg[0];
#pragma unroll
    for (int i = 1; i < 4; ++i) if (lg[i] > gm) { gm = lg[i]; g = i; }
    float gs = 0.f;
#pragma unroll
    for (int i = 0; i < 4; ++i) gs += __expf(lg[i] - gm);
    const float gw = 1.f / gs;
    float e[4];
#pragma unroll
    for (int i = 0; i < 4; ++i) { e[i] = lg[4 + i];
#pragma unroll
        for (int gg = 1; gg < 4; ++gg) if (g == gg) e[i] = lg[4 + gg * 4 + i]; }
    int i1 = 0; float v1 = e[0];
#pragma unroll
    for (int i = 1; i < 4; ++i) if (e[i] > v1) { v1 = e[i]; i1 = i; }
    int i2 = -1; float v2 = -3e38f;
#pragma unroll
    for (int i = 0; i < 4; ++i) if (i != i1 && e[i] > v2) { v2 = e[i]; i2 = i; }
    const float p1 = 1.f / (1.f + __expf(v2 - v1)), p2 = 1.f - p1;
    if (lane == 0) { float4 r; r.x = (float)(g * 4 + i1); r.y = (float)(g * 4 + i2); r.z = p1 * gw; r.w = p2 * gw; *(float4*)(route + (size_t)token * 4) = r; }
}
template <typename T> __global__ __launch_bounds__(256) void k_moe(const T* hn, const float* hres, const float* route, const float* w_gate, const float* w_up, const float* w_down, const float* g_final, float* out) {
    __shared__ float xs[1024]; __shared__ float act[256]; __shared__ float red[4];
    const int token = blockIdx.x, tid = threadIdx.x;
#pragma unroll
    for (int i = 0; i < 4; ++i) xs[tid + 256 * i] = ldf(hn + (size_t)token * 1024 + tid + 256 * i);
    const float4 rt = *(const float4*)(route + (size_t)token * 4);
    float o[4] = {0.f, 0.f, 0.f, 0.f};
    __syncthreads();
    for (int s = 0; s < 2; ++s) {
        const int e = (int)(s == 0 ? rt.x : rt.y); const float w = (s == 0 ? rt.z : rt.w);
        const float* wg = w_gate + (size_t)e * 1024 * 256 + tid; const float* wu = w_up + (size_t)e * 1024 * 256 + tid;
        float ga = 0.f, ua = 0.f;
#pragma unroll 8
        for (int k = 0; k < 1024; ++k) { const float x = xs[k]; ga += x * wg[(size_t)k * 256]; ua += x * wu[(size_t)k * 256]; }
        const float a = ga / (1.f + __expf(-ga)) * ua * w;
        __syncthreads();
        act[tid] = a;
        __syncthreads();
        const float* wd = w_down + (size_t)e * 256 * 1024 + tid;
#pragma unroll 8
        for (int f = 0; f < 256; ++f) { const float a2 = act[f];
#pragma unroll
            for (int i = 0; i < 4; ++i) o[i] += a2 * wd[(size_t)f * 1024 + 256 * i]; }
    }
    float ss = 0.f;
#pragma unroll
    for (int i = 0; i < 4; ++i) { o[i] += hres[(size_t)token * 1024 + tid + 256 * i]; ss += o[i] * o[i]; }
    ss = wave_sum(ss);
    if ((tid & 63) == 0) red[tid >> 6] = ss;
    __syncthreads();
    const float r = rsqrtf((red[0] + red[1] + red[2] + red[3]) / 1024.f + EPS);
#pragma unroll
    for (int i = 0; i < 4; ++i) out[(size_t)token * 1024 + tid + 256 * i] = o[i] * r * g_final[tid + 256 * i];
}

extern "C" void kernel_launch(void* const* d_in, const int* in_sizes, int n_in, void* d_out, int out_size, void* d_ws, size_t ws_size, hipStream_t stream) {
    static int grid = 0;
    if (grid == 0) {
        if (n_in != 16 || in_sizes[0] != M * D || out_size != M * D || ws_size < WS_END) { fprintf(stderr, "kernel_launch: unexpected shapes / workspace (%d inputs, in0 %d, out %d, ws %zu)\n", n_in, n_in > 0 ? in_sizes[0] : -1, out_size, ws_size); grid = -1; return; }
        int dev = 0, cus = 0, per_cu = 0;
        if (hipGetDevice(&dev) != hipSuccess || hipDeviceGetAttribute(&cus, hipDeviceAttributeMultiprocessorCount, dev) != hipSuccess) { grid = -1; return; }
        if (hipFuncSetAttribute((const void*)mega_fwd, hipFuncAttributeMaxDynamicSharedMemorySize, LDS_BYTES) != hipSuccess) { fprintf(stderr, "kernel_launch: hipFuncSetAttribute failed\n"); grid = -1; return; }
        if (hipOccupancyMaxActiveBlocksPerMultiprocessor(&per_cu, (const void*)mega_fwd, 512, LDS_BYTES) != hipSuccess || per_cu < 1) { fprintf(stderr, "kernel_launch: occupancy query says %d blocks per CU\n", per_cu); per_cu = 1; }
        (void)hipGetLastError();
        grid = cus;
    }
    if (grid < 0) return;
    (void)hipMemsetAsync((char*)d_ws + WS_CTL, 0, CTL_ZERO_BYTES, stream);
    Args a{};
    const float** pp = (const float**)&a.p;
    for (int i = 0; i < 16; ++i) pp[i] = (const float*)d_in[i];
    a.p.out = (float*)d_out; a.p.ws = (unsigned char*)d_ws;
    const Ptrs& P = a.p;
    auto run = [&](int lo, int hi) { a.ph_lo = lo; a.ph_hi = hi; hipLaunchKernelGGL(mega_fwd, dim3(grid), dim3(512), LDS_BYTES, stream, a); };
#if FAST_UPTO >= 7
    run(0, N_PHASES);
#else
    for (int ph = 0; ph <= FAST_UPTO; ++ph) run(ph, ph + 1);
    float* bufA = (float*)(P.ws + WS_NAIVE);
    float* hn = (float*)(P.ws + WS_QKV);
    float* route = (float*)(P.ws + WS_ROUTE);
#if FAST_UPTO <= 1
    k_dil<bf16><<<M * 8 / 4, 256, 0, stream>>>((const bf16*)(P.ws + WS_QKV), bufA, QSCALE);
    k_na<bf16><<<M * 8 / 4, 256, 0, stream>>>((const bf16*)(P.ws + WS_QKV), P.rpb, bufA, QSCALE);
#endif
#if FAST_UPTO == 2
    k_cvt<<<M * 1024 / 256, 256, 0, stream>>>((const bf16*)(P.ws + WS_Y), bufA);
#endif
#if FAST_UPTO <= 2
    k_rms<512><<<M / 4, 256, 0, stream>>>(bufA, P.g_out_dil, bufA, 0);
    k_rms<512><<<M / 4, 256, 0, stream>>>(bufA, P.g_out_na, bufA, 512);
    k_gemm<<<dim3(D / 128, M / 128), 256, 0, stream>>>(bufA, P.w_out, P.out, P.x, M, D, D);
#endif
#if FAST_UPTO <= 3
    k_rms<1024><<<M / 4, 256, 0, stream>>>(P.out, P.norm_ffn_g, hn, 0);
    k_router<<<M / 4, 256, 0, stream>>>(hn, P.w_group, P.b_group, P.w_router, P.b_router, route);
    k_moe<float><<<M, 256, 0, stream>>>(hn, P.out, route, P.w_gate, P.w_up, P.w_down, P.norm_final_g, P.out);
#elif FAST_UPTO == 4
    k_moe<bf16><<<M, 256, 0, stream>>>((const bf16*)(P.ws + WS_XN), P.out, route, P.w_gate, P.w_up, P.w_down, P.norm_final_g, P.out);
#else
    for (int ph = FAST_UPTO + 1; ph < N_PHASES; ++ph) run(ph, ph + 1);
#endif
#endif
}
```
